# Optimizing an MI355X kernel written in HIP

```python
import jax, jax.numpy as jnp
from jax import lax
import numpy as np

D_MODEL = 1024
BATCH = 1
SEQ = 16384
DEPTH = 1

D_MIX = D_MODEL
GLA_HEADS = 4
GLA_DV = 128
GLA_DK = 64
GLA_KEY = GLA_HEADS * GLA_DK
GLA_VAL = GLA_HEADS * GLA_DV
GATE_RANK = 16
GATE_TAU = 16.0
CHUNK = 64
CONV_CH = D_MIX - GLA_VAL
CONV_GROUPS = 8
CONV_W = 31
D_FF = 4 * D_MODEL
EPS = 1e-6

OFF_Q = 0
OFF_K = OFF_Q + GLA_KEY
OFF_V = OFF_K + GLA_KEY
OFF_G = OFF_V + GLA_VAL
OFF_A = OFF_G + GLA_VAL
OFF_C = OFF_A + GATE_RANK
D_IN = OFF_C + 2 * CONV_CH

kernel_name = "hybrid_gla_conformer_conv_block"


def rmsnorm(x, g):
    xf = x.astype(jnp.float32)
    y = xf * lax.rsqrt(jnp.mean(xf * xf, axis=-1, keepdims=True) + EPS)
    return (y * g.astype(jnp.float32)).astype(x.dtype)


def gla_chunked(q, k, v, log_a):
    B, S, H, DK = q.shape
    DV = v.shape[-1]
    nc = S // CHUNK

    def to_chunks(t):
        return t.astype(jnp.float32).reshape(B, nc, CHUNK, H, t.shape[-1]).transpose(1, 0, 3, 2, 4)

    qc, kc, vc, ac = map(to_chunks, (q, k, v, log_a))
    bc = jnp.cumsum(ac, axis=3)
    causal = jnp.tril(jnp.ones((CHUNK, CHUNK), dtype=bool))

    def step(state, inp):
        qi, ki, vi, bi = inp
        o_inter = jnp.einsum('bhcd,bhde->bhce', qi * jnp.exp(bi), state)
        diff = bi[:, :, :, None, :] - bi[:, :, None, :, :]
        decay = jnp.exp(jnp.where(causal[:, :, None], diff, -jnp.inf))
        scores = jnp.einsum('bhid,bhjd,bhijd->bhij', qi, ki, decay)
        o_intra = jnp.einsum('bhij,bhje->bhie', scores, vi)
        b_last = bi[:, :, -1, :]
        k_dec = ki * jnp.exp(b_last[:, :, None, :] - bi)
        new_state = jnp.exp(b_last)[..., None] * state + jnp.einsum('bhcd,bhce->bhde', k_dec, vi)
        return new_state, o_inter + o_intra

    s0 = jnp.zeros((B, H, DK, DV), jnp.float32)
    _, o = lax.scan(step, s0, (qc, kc, vc, bc))
    return o.transpose(1, 0, 3, 2, 4).reshape(B, S, H, DV).astype(v.dtype)


def causal_depthwise_conv(u, w, b):
    u_pad = jnp.pad(u, ((0, 0), (CONV_W - 1, 0), (0, 0)))
    y = lax.conv_general_dilated(
        u_pad, w[:, None, :].astype(u.dtype), window_strides=(1,), padding='VALID',
        dimension_numbers=('NWC', 'WIO', 'NWC'), feature_group_count=u.shape[-1])
    return y + b.astype(u.dtype)


def channel_group_norm(u, g, b):
    B, S, C = u.shape
    uf = u.astype(jnp.float32).reshape(B, S, CONV_GROUPS, C // CONV_GROUPS)
    mu = jnp.mean(uf, axis=-1, keepdims=True)
    var = jnp.mean(jnp.square(uf - mu), axis=-1, keepdims=True)
    y = ((uf - mu) * lax.rsqrt(var + EPS)).reshape(B, S, C)
    return (y * g.astype(jnp.float32) + b.astype(jnp.float32)).astype(u.dtype)


def setup_inputs(seed: int = 0) -> dict:
    key = jax.random.key(seed)
    ks = jax.random.split(key, 16)
    f32 = jnp.float32
    nrm = lambda k, shape, s: jax.random.normal(k, shape, f32) * s
    return {
        "x": jax.random.normal(ks[0], (BATCH, SEQ, D_MODEL), f32),
        "norm1_g": 1.0 + nrm(ks[1], (DEPTH, D_MODEL), 0.02),
        "w_in": nrm(ks[2], (DEPTH, D_MODEL, D_IN), D_MODEL ** -0.5),
        "w_gate_up": nrm(ks[3], (DEPTH, GATE_RANK, GLA_KEY), GATE_RANK ** -0.5),
        "b_gate": nrm(ks[4], (DEPTH, GLA_KEY), 0.1),
        "gla_norm_g": 1.0 + nrm(ks[5], (DEPTH, GLA_DV), 0.02),
        "conv_w": nrm(ks[6], (DEPTH, CONV_W, CONV_CH), CONV_W ** -0.5),
        "conv_b": nrm(ks[7], (DEPTH, CONV_CH), 0.02),
        "conv_norm_g": 1.0 + nrm(ks[8], (DEPTH, CONV_CH), 0.02),
        "conv_norm_b": nrm(ks[9], (DEPTH, CONV_CH), 0.02),
        "w_out": nrm(ks[10], (DEPTH, D_MIX, D_MODEL), D_MIX ** -0.5),
        "norm2_g": 1.0 + nrm(ks[11], (DEPTH, D_MODEL), 0.02),
        "w_mlp_in": nrm(ks[12], (DEPTH, D_MODEL, D_FF), D_MODEL ** -0.5),
        "w_mlp_out": nrm(ks[13], (DEPTH, D_FF, D_MODEL), D_FF ** -0.5),
        "final_norm_g": 1.0 + nrm(ks[14], (D_MODEL,), 0.02),
    }


def reference(x, norm1_g, w_in, w_gate_up, b_gate, gla_norm_g, conv_w, conv_b,
              conv_norm_g, conv_norm_b, w_out, norm2_g, w_mlp_in, w_mlp_out,
              final_norm_g):
    B, S, _ = x.shape
    h = x
    for l in range(DEPTH):
        xn = rmsnorm(h, norm1_g[l])
        proj = jnp.einsum('bsd,de->bse', xn, w_in[l])

        q = proj[..., OFF_Q:OFF_K].reshape(B, S, GLA_HEADS, GLA_DK) * (GLA_DK ** -0.5)
        k = proj[..., OFF_K:OFF_V].reshape(B, S, GLA_HEADS, GLA_DK)
        v = proj[..., OFF_V:OFF_G].reshape(B, S, GLA_HEADS, GLA_DV)
        g = proj[..., OFF_G:OFF_A]
        z = proj[..., OFF_A:OFF_C]
        a_logit = jnp.einsum('bsr,rk->bsk', z, w_gate_up[l]) + b_gate[l]
        log_a = (jax.nn.log_sigmoid(a_logit.astype(jnp.float32)) / GATE_TAU).reshape(B, S, GLA_HEADS, GLA_DK)
        o_gla = gla_chunked(q, k, v, log_a)
        o_gla = rmsnorm(o_gla, gla_norm_g[l]).reshape(B, S, GLA_VAL) * jax.nn.silu(g)

        c_in = proj[..., OFF_C:OFF_C + CONV_CH]
        c_gate = proj[..., OFF_C + CONV_CH:D_IN]
        u = c_in * jax.nn.sigmoid(c_gate)
        u = causal_depthwise_conv(u, conv_w[l], conv_b[l])
        o_conv = jax.nn.silu(channel_group_norm(u, conv_norm_g[l], conv_norm_b[l]))

        mixed = jnp.concatenate([o_gla, o_conv], axis=-1)
        h = h + jnp.einsum('bse,ed->bsd', mixed, w_out[l])

        hn = rmsnorm(h, norm2_g[l])
        ff = jnp.square(jax.nn.relu(jnp.einsum('bsd,df->bsf', hn, w_mlp_in[l])))
        h = h + jnp.einsum('bsf,fd->bsd', ff, w_mlp_out[l])
    return rmsnorm(h, final_norm_g)
```

```cpp
#include <hip/hip_runtime.h>
#include <cstdio>
#include <cstdint>
namespace pg8 {
#define PG8_LAS __attribute__((address_space(3)))
typedef unsigned short bf16_t;
typedef short bf16x8 __attribute__((ext_vector_type(8)));
typedef float f32x4 __attribute__((ext_vector_type(4)));
typedef unsigned u32x4 __attribute__((ext_vector_type(4)));
constexpr int BM = 256, BK = 64, HALF = 128, HTB = HALF * BK * 2  , STAGE_BYTES = 8 * HTB, NXCD = 8, WGM = 8;

__host__ __device__ __forceinline__ int lds_byte(int r, int c) { const int st = (r >> 4) * 2 + (c >> 5), rr = r & 15, cc = c & 31, ob = rr * 64 + cc * 2; return st * 1024 + (ob ^ (((ob >> 9) & 1) << 5)); }
__host__ __device__ __forceinline__ void stage_rc(int b, int& R, int& C) { const int st = b / 1024, sb = b % 1024, swz = sb ^ (((sb >> 9) & 1) << 5); R = (st >> 1) * 16 + swz / 64; C = (st & 1) * 32 + (swz % 64) / 2; }
__host__ __device__ __forceinline__ int perm32(int rho) { const int n = rho >> 4, i = rho & 15; return 8 * (i >> 2) + 4 * n + (i & 3); }

struct Unit { int pm, pn; };
struct Gemm { const bf16_t* A; const bf16_t* Bt; int M, N, K; };

struct StaticOrder {
    int nM, nN, nwg, G, c;
    __host__ __device__ void init(int M, int N, int G_, int c_) { nM = M / BM; nN = N / BM; nwg = nM * nN; G = G_; c = c_; }
    __host__ __device__ bool next(int i, Unit& u) const {
        const long L = (long)i * G + c; if (L >= nwg) return false;
        int wgid = (int)L; { const int q = nwg / NXCD, r = nwg % NXCD, xcd = wgid % NXCD, off = wgid / NXCD; wgid = (xcd < r ? xcd * (q + 1) : r * (q + 1) + (xcd - r) * q) + off; }
        const int nig = WGM * nN, gid = wgid / nig, fm = gid * WGM, gsz = (nM - fm) < WGM ? (nM - fm) : WGM;
        u.pm = fm + ((wgid % nig) % gsz); u.pn = (wgid % nig) / gsz; return true;
    }
    __device__ __forceinline__ void a_ready(const Unit&) const {}
    __device__ __forceinline__ void done(const Unit&) const {}
};

__device__ __forceinline__ unsigned cvt_pk_bf16(float lo, float hi) { unsigned r; asm volatile("v_cvt_pk_bf16_f32 %0, %1, %2" : "=v"(r) : "v"(lo), "v"(hi)); return r; }
typedef float f32x2 __attribute__((ext_vector_type(2)));
__device__ __forceinline__ f32x2 gelu_pk(f32x2 v) {
    const f32x2 av = __builtin_elementwise_abs(v), d = av * 0.2316418882f + 1.0f;
    f32x2 t; t.x = __builtin_amdgcn_rcpf(d.x); t.y = __builtin_amdgcn_rcpf(d.y);
    f32x2 q = t * 0.5307027145f + (-0.7265760135f); q = q * t + 0.7107068705f; q = q * t + (-0.142248368f); q = q * t + 0.127414796f; q = q * t;
    const f32x2 s = (v * v) * (-0.72134752044f);
    f32x2 e; e.x = __builtin_amdgcn_exp2f(s.x); e.y = __builtin_amdgcn_exp2f(s.y);
    const f32x2 m = v * (q * e), r = v - m;
    f32x2 o; o.x = v.x < 0.f ? m.x : r.x; o.y = v.y < 0.f ? m.y : r.y; return o;
}

template <int ACT  > struct EpiBf16 {
    static constexpr bool PERM = true, AFTER_DRAIN = false; static_assert(ACT == 0 || ACT == 1, "EpiBf16: ACT is 0 (none) or 1 (gelu_pk)");
    bf16_t* O; int ldc; const float* bias; int split_cols; size_t split_stride; float scale0;
    __device__ __forceinline__ void operator()(const f32x4 (&acc)[2][2][4][2], const Unit& u, int wr, int wc, int fr, int fq) const {
        const int row0 = u.pm * BM + wr * 64 + fr; int colt = u.pn * BM; bf16_t* base = O;
        float sc = 1.f; if (split_cols) { const int t = colt / split_cols; base += (size_t)t * split_stride; colt -= t * split_cols; if (t == 0) sc = scale0; }
        const int col0 = colt + wc * 32 + 8 * fq, bcol0 = u.pn * BM + wc * 32 + 8 * fq;
        f32x4 bv[2][2];
#pragma unroll
        for (int bj = 0; bj < 2; ++bj)
#pragma unroll
            for (int n = 0; n < 2; ++n) bv[bj][n] = bias ? *(const f32x4*)(bias + bcol0 + bj * HALF + 4 * n) : (f32x4){0.f, 0.f, 0.f, 0.f};
#pragma unroll
        for (int ai = 0; ai < 2; ++ai)
#pragma unroll
            for (int m = 0; m < 4; ++m) { bf16_t* rowp = base + (size_t)(row0 + ai * HALF + m * 16) * ldc + col0;
#pragma unroll
                for (int bj = 0; bj < 2; ++bj) { f32x4 v0 = acc[ai][bj][m][0] + bv[bj][0], v1 = acc[ai][bj][m][1] + bv[bj][1];
                    if (ACT == 1) { f32x2 a = gelu_pk((f32x2){v0[0], v0[1]}), b = gelu_pk((f32x2){v0[2], v0[3]}), c = gelu_pk((f32x2){v1[0], v1[1]}), d = gelu_pk((f32x2){v1[2], v1[3]});
                        v0 = (f32x4){a.x, a.y, b.x, b.y}; v1 = (f32x4){c.x, c.y, d.x, d.y}; }
                    v0 = v0 * sc; v1 = v1 * sc; u32x4 w; w.x = cvt_pk_bf16(v0[0], v0[1]); w.y = cvt_pk_bf16(v0[2], v0[3]); w.z = cvt_pk_bf16(v1[0], v1[1]); w.w = cvt_pk_bf16(v1[2], v1[3]);
                    *(u32x4*)(rowp + bj * HALF) = w; } }
    }
};
struct EpiResid {
    static constexpr bool PERM = true, AFTER_DRAIN = false;
    const float* base; float* out; bf16_t* outb; float* ssq; int ldc;
    __device__ __forceinline__ void operator()(const f32x4 (&acc)[2][2][4][2], const Unit& u, int wr, int wc, int fr, int fq) const {
        const int row0 = u.pm * BM + wr * 64 + fr, col0 = u.pn * BM + wc * 32 + 8 * fq;
#pragma unroll
        for (int ai = 0; ai < 2; ++ai)
#pragma unroll
            for (int m = 0; m < 4; ++m) { const int row = row0 + ai * HALF + m * 16; const size_t off = (size_t)row * ldc + col0; float s = 0.f;
#pragma unroll
                for (int bj = 0; bj < 2; ++bj) { const f32x4 b0 = *(const f32x4*)(base + off + bj * HALF), b1 = *(const f32x4*)(base + off + bj * HALF + 4);
                    const f32x4 v0 = acc[ai][bj][m][0] + b0, v1 = acc[ai][bj][m][1] + b1;
                    *(f32x4*)(out + off + bj * HALF) = v0; *(f32x4*)(out + off + bj * HALF + 4) = v1;
                    s += (v0[0] * v0[0] + v0[1] * v0[1]) + (v0[2] * v0[2] + v0[3] * v0[3]); s += (v1[0] * v1[0] + v1[1] * v1[1]) + (v1[2] * v1[2] + v1[3] * v1[3]);
                    if (outb) { u32x4 w; w.x = cvt_pk_bf16(v0[0], v0[1]); w.y = cvt_pk_bf16(v0[2], v0[3]); w.z = cvt_pk_bf16(v1[0], v1[1]); w.w = cvt_pk_bf16(v1[2], v1[3]); *(u32x4*)(outb + off + bj * HALF) = w; } }
                s += __shfl_xor(s, 16); s += __shfl_xor(s, 32);
                if (fq == 0) ssq[(size_t)row * 16 + u.pn * 4 + wc] = s; }
    }
};
struct EpiRelu2 {
    static constexpr bool PERM = true, AFTER_DRAIN = false;
    bf16_t* O; int ldc; const float* ssq; float inv_n, eps;
    __device__ __forceinline__ void operator()(const f32x4 (&acc)[2][2][4][2], const Unit& u, int wr, int wc, int fr, int fq) const {
        const int row0 = u.pm * BM + wr * 64 + fr, col0 = u.pn * BM + wc * 32 + 8 * fq;
#pragma unroll
        for (int ai = 0; ai < 2; ++ai)
#pragma unroll
            for (int m = 0; m < 4; ++m) { const int row = row0 + ai * HALF + m * 16; const f32x4* sp = (const f32x4*)(ssq + (size_t)row * 16);
                const f32x4 a = sp[0], b = sp[1], c = sp[2], d = sp[3];
                const float t = ((a[0] + a[1]) + (a[2] + a[3])) + ((b[0] + b[1]) + (b[2] + b[3])) + ((c[0] + c[1]) + (c[2] + c[3])) + ((d[0] + d[1]) + (d[2] + d[3]));
                const float rs = 1.0f / sqrtf(t * inv_n + eps);
                bf16_t* rowp = O + (size_t)row * ldc + col0;
#pragma unroll
                for (int bj = 0; bj < 2; ++bj) { f32x4 v0 = acc[ai][bj][m][0] * rs, v1 = acc[ai][bj][m][1] * rs;
#pragma unroll
                    for (int e = 0; e < 4; ++e) { v0[e] = fmaxf(v0[e], 0.f); v1[e] = fmaxf(v1[e], 0.f); }
                    v0 = v0 * v0; v1 = v1 * v1;
                    u32x4 w; w.x = cvt_pk_bf16(v0[0], v0[1]); w.y = cvt_pk_bf16(v0[2], v0[3]); w.z = cvt_pk_bf16(v1[0], v1[1]); w.w = cvt_pk_bf16(v1[2], v1[3]);
                    *(u32x4*)(rowp + bj * HALF) = w; } }
    }
};

template <class Epi, class Sched, bool ALIGN_EPI = false, bool SP2 = false>
__device__ __forceinline__ void gemm_phase(PG8_LAS unsigned char* lds, const Gemm g, const Sched& S, const Epi& E) {
    const int tid = threadIdx.x, wid = __builtin_amdgcn_readfirstlane(tid >> 6), lane = tid & 63, wr = wid >> 2, wc = wid & 3, fr = lane & 15, fq = lane >> 4;
    const int K = g.K, nt = K / BK;
    unsigned voffA[2], voffB[2];
#pragma unroll
    for (int i = 0; i < 2; ++i) { int R, C; stage_rc(tid * 16 + i * 8192, R, C); const int Rb = Epi::PERM ? ((R & ~31) + perm32(R & 31)) : R;
        voffA[i] = (unsigned)(R * K + C) * 2u; voffB[i] = (unsigned)(Rb * K + C) * 2u; }
    const size_t kstep = (size_t)(BK * 2);
    const size_t hstep = (size_t)HALF * K * 2;
    const size_t tstep = 2 * hstep;
    const unsigned ldsw = (unsigned)wid * 1024u;
    const int aoff = lds_byte(wr * 64 + fr, fq * 8), boff = lds_byte(wc * 32 + fr, fq * 8);
#define PG8_SA(b, h) (((b) * 2 + (h)) * HTB)
#define PG8_SB(b, h) ((4 + (b) * 2 + (h)) * HTB)
#define PG8_STAGE(bufoff, gbase, voff) do { _Pragma("unroll") for (int _i = 0; _i < 2; ++_i) \
        __builtin_amdgcn_global_load_lds((const unsigned*)((const char*)(gbase) + (voff)[_i]), (PG8_LAS unsigned*)(lds + (bufoff) + ldsw + _i * 8192), 16, 0, 0); } while (0)
#define PG8_LDA(dst, b, h) do { _Pragma("unroll") for (int m = 0; m < 4; ++m) _Pragma("unroll") for (int k = 0; k < 2; ++k) dst[m][k] = *(const PG8_LAS bf16x8*)(lds + PG8_SA(b, h) + aoff + m * 2048 + k * 1024); } while (0)
#define PG8_LDB(dst, b, h) do { _Pragma("unroll") for (int n = 0; n < 2; ++n) _Pragma("unroll") for (int k = 0; k < 2; ++k) dst[n][k] = *(const PG8_LAS bf16x8*)(lds + PG8_SB(b, h) + boff + n * 2048 + k * 1024); } while (0)
#define PG8_MMA(ai, bj, At, Bt) do { __builtin_amdgcn_s_setprio(1); _Pragma("unroll") for (int m = 0; m < 4; ++m) _Pragma("unroll") for (int n = 0; n < 2; ++n) _Pragma("unroll") for (int k = 0; k < 2; ++k) \
        acc[ai][bj][m][n] = __builtin_amdgcn_mfma_f32_16x16x32_bf16(Bt[n][k], At[m][k], acc[ai][bj][m][n], 0, 0, 0); __builtin_amdgcn_s_setprio(0); } while (0)
#define PG8_WAIT_V(n) asm volatile("s_waitcnt vmcnt(" #n ")" ::: "memory")
#define PG8_WAIT_L(n) asm volatile("s_waitcnt lgkmcnt(" #n ")" ::: "memory")
#define PG8_BAR __builtin_amdgcn_s_barrier()
#define PG8_SCHED __builtin_amdgcn_sched_barrier(0)
    Unit cur, nxt; int ui = 0;
    if (!S.next(0, cur)) return;
    f32x4 acc[2][2][4][2];
#pragma unroll
    for (int a = 0; a < 2; ++a)
#pragma unroll
        for (int b = 0; b < 2; ++b)
#pragma unroll
            for (int m = 0; m < 4; ++m)
#pragma unroll
                for (int n = 0; n < 2; ++n) acc[a][b][m][n] = (f32x4){0.f, 0.f, 0.f, 0.f};
    bf16x8 At[4][2], B0[2][2], B1[2][2];
    const char* cA = (const char*)g.A + (size_t)cur.pm * tstep; const char* cB = (const char*)g.Bt + (size_t)cur.pn * tstep;
    S.a_ready(cur);
    if constexpr (SP2) {
        PG8_STAGE(PG8_SB(0, 0), cB, voffB); PG8_STAGE(PG8_SB(0, 1), cB + hstep, voffB); PG8_STAGE(PG8_SA(0, 0), cA, voffA); PG8_STAGE(PG8_SA(0, 1), cA + hstep, voffA);
        if (wr == 1) PG8_BAR;
        PG8_WAIT_V(2); PG8_BAR;
        PG8_STAGE(PG8_SB(1, 0), cB + kstep, voffB); PG8_STAGE(PG8_SA(1, 0), cA + kstep, voffA); PG8_STAGE(PG8_SB(1, 1), cB + hstep + kstep, voffB);
        PG8_WAIT_V(6); PG8_BAR;
    } else {
        PG8_STAGE(PG8_SB(0, 0), cB, voffB); PG8_STAGE(PG8_SA(0, 0), cA, voffA); PG8_STAGE(PG8_SB(0, 1), cB + hstep, voffB); PG8_STAGE(PG8_SA(0, 1), cA + hstep, voffA);
        if (wr == 1) PG8_BAR;
        PG8_WAIT_V(4); PG8_BAR;
        PG8_STAGE(PG8_SB(1, 0), cB + kstep, voffB); PG8_STAGE(PG8_SA(1, 0), cA + kstep, voffA); PG8_STAGE(PG8_SB(1, 1), cB + hstep + kstep, voffB);
        PG8_WAIT_V(6); PG8_BAR;
    }
    for (;;) {
        const bool has_next = S.next(ui + 1, nxt);
        const char* nA = has_next ? (const char*)g.A + (size_t)nxt.pm * tstep : cA; const char* nB = has_next ? (const char*)g.Bt + (size_t)nxt.pn * tstep : cB;
        for (int t = 0; t < nt; t += 2) {
            const bool last = (t == nt - 2);
            const char* a1 = cA + (size_t)(t + 1) * kstep;
            const char* a2 = last ? nA : cA + (size_t)(t + 2) * kstep; const char* b2 = last ? nB : cB + (size_t)(t + 2) * kstep;
            const char* a3 = a2 + kstep; const char* b3 = b2 + kstep;
            if (last && has_next) S.a_ready(nxt);
            if constexpr (SP2) {
            PG8_LDB(B0, 0, 0); PG8_LDB(B1, 0, 1); PG8_SCHED; PG8_LDA(At, 0, 0); PG8_STAGE(PG8_SA(1, 1), a1 + hstep, voffA);
            PG8_WAIT_V(8); PG8_WAIT_L(0); PG8_BAR; PG8_MMA(0, 0, At, B0); PG8_MMA(0, 1, At, B1); PG8_BAR; PG8_SCHED;
            PG8_LDA(At, 0, 1); PG8_STAGE(PG8_SB(0, 0), b2, voffB); PG8_STAGE(PG8_SB(0, 1), b2 + hstep, voffB); PG8_STAGE(PG8_SA(0, 0), a2, voffA);
            PG8_WAIT_V(8); PG8_WAIT_L(0); PG8_BAR; PG8_MMA(1, 0, At, B0); PG8_MMA(1, 1, At, B1); PG8_BAR; PG8_SCHED;
            PG8_LDB(B0, 1, 0); PG8_LDB(B1, 1, 1); PG8_SCHED; PG8_LDA(At, 1, 0); PG8_STAGE(PG8_SA(0, 1), a2 + hstep, voffA);
            PG8_WAIT_V(8); PG8_WAIT_L(0); PG8_BAR; PG8_MMA(0, 0, At, B0); PG8_MMA(0, 1, At, B1); PG8_BAR; PG8_SCHED;
            PG8_LDA(At, 1, 1); PG8_STAGE(PG8_SB(1, 0), b3, voffB); PG8_STAGE(PG8_SB(1, 1), b3 + hstep, voffB); PG8_STAGE(PG8_SA(1, 0), a3, voffA);
            PG8_WAIT_V(8); PG8_WAIT_L(0); PG8_BAR; PG8_MMA(1, 0, At, B0); PG8_MMA(1, 1, At, B1); PG8_BAR; PG8_SCHED;
            } else {
            PG8_LDB(B0, 0, 0); PG8_SCHED; PG8_LDA(At, 0, 0); PG8_STAGE(PG8_SA(1, 1), a1 + hstep, voffA);
            PG8_WAIT_L(8); PG8_BAR; PG8_WAIT_L(0); PG8_MMA(0, 0, At, B0); PG8_BAR; PG8_SCHED;
            PG8_LDB(B1, 0, 1); PG8_STAGE(PG8_SB(0, 0), b2, voffB);
            PG8_BAR; PG8_WAIT_L(0); PG8_MMA(0, 1, At, B1); PG8_BAR;
            PG8_LDA(At, 0, 1); PG8_STAGE(PG8_SA(0, 0), a2, voffA);
            PG8_BAR; PG8_WAIT_L(0); PG8_MMA(1, 0, At, B0); PG8_BAR; PG8_SCHED;
            PG8_STAGE(PG8_SB(0, 1), b2 + hstep, voffB);
            PG8_WAIT_V(6); PG8_BAR; PG8_MMA(1, 1, At, B1); PG8_BAR;
            PG8_LDB(B0, 1, 0); PG8_SCHED; PG8_LDA(At, 1, 0); PG8_STAGE(PG8_SA(0, 1), a2 + hstep, voffA);
            PG8_WAIT_L(8); PG8_BAR; PG8_WAIT_L(0); PG8_MMA(0, 0, At, B0); PG8_BAR; PG8_SCHED;
            PG8_LDB(B1, 1, 1); PG8_STAGE(PG8_SB(1, 0), b3, voffB);
            PG8_BAR; PG8_WAIT_L(0); PG8_MMA(0, 1, At, B1); PG8_BAR;
            PG8_LDA(At, 1, 1); PG8_STAGE(PG8_SA(1, 0), a3, voffA);
            PG8_BAR; PG8_WAIT_L(0); PG8_MMA(1, 0, At, B0); PG8_BAR; PG8_SCHED;
            PG8_STAGE(PG8_SB(1, 1), b3 + hstep, voffB);
            PG8_WAIT_V(6); PG8_BAR; PG8_MMA(1, 1, At, B1); PG8_BAR;
            }
        }
        if constexpr (ALIGN_EPI) { if (wr == 0) PG8_BAR; }
        if constexpr (!Epi::AFTER_DRAIN) { E(acc, cur, wr, wc, fr, fq); S.done(cur); }
        if (!has_next) break;
#pragma unroll
        for (int a = 0; a < 2; ++a)
#pragma unroll
            for (int b = 0; b < 2; ++b)
#pragma unroll
                for (int m = 0; m < 4; ++m)
#pragma unroll
                    for (int n = 0; n < 2; ++n) acc[a][b][m][n] = (f32x4){0.f, 0.f, 0.f, 0.f};
        cur = nxt; cA = nA; cB = nB; ++ui;
        if constexpr (ALIGN_EPI) { if (wr == 1) PG8_BAR; }
    }
    PG8_WAIT_V(0);
    if constexpr (!ALIGN_EPI) { if (wr == 0) PG8_BAR; }
    PG8_BAR;
    if constexpr (Epi::AFTER_DRAIN) { E.fused(acc, cur, wr, wc, fr, fq, lds, wid, lane); S.done(cur); }
#undef PG8_SA
#undef PG8_SB
#undef PG8_STAGE
#undef PG8_LDA
#undef PG8_LDB
#undef PG8_MMA
#undef PG8_WAIT_V
#undef PG8_WAIT_L
#undef PG8_BAR
#undef PG8_SCHED
}
}

#ifndef PG8_SP2
#define PG8_SP2 true
#endif
#ifndef PG8_ALIGN
#define PG8_ALIGN true
#endif
#define GAS __attribute__((address_space(1)))
#define LAS __attribute__((address_space(3)))
typedef unsigned short bf16;
typedef unsigned v4u __attribute__((ext_vector_type(4)));
typedef float f32x4 __attribute__((ext_vector_type(4)));
typedef short bf16x8 __attribute__((ext_vector_type(8)));
typedef GAS unsigned gu32;
typedef GAS unsigned long long gu64;
#define RLX_AGENT __ATOMIC_RELAXED, __HIP_MEMORY_SCOPE_AGENT
#define LDS_WAIT() asm volatile("s_waitcnt lgkmcnt(0)" ::: "memory")
#define VM_WAIT() asm volatile("s_waitcnt vmcnt(0)" ::: "memory")
__device__ __forceinline__ unsigned long long rt() { return __builtin_amdgcn_s_memrealtime(); }
__device__ __forceinline__ unsigned f2bf(float f) { unsigned u = __builtin_bit_cast(unsigned, f); return (u + 0x7fffu + ((u >> 16) & 1u)) >> 16; }
__device__ __forceinline__ unsigned pk2(float lo, float hi) { return f2bf(lo) | (f2bf(hi) << 16); }

#define XB_TMO      128
#define XB_XCNT(j)  (256  + 64 * (j))
#define XB_XSUB(j)  (1280 + 64 * (j))
#define XB_XGEN(j)  (2304 + 64 * (j))
#define XB_TOP      3328
#define XB_TOPGEN   3392
#define XCD_BAR_WORDS 3456
#define XB_SPIN_CAP (1u << 18)

__device__ __forceinline__ unsigned xb_ld(unsigned* p)              { return __hip_atomic_load(p, __ATOMIC_RELAXED, __HIP_MEMORY_SCOPE_AGENT); }
__device__ __forceinline__ unsigned xb_add(unsigned* p, unsigned v) { return __hip_atomic_fetch_add(p, v, __ATOMIC_RELAXED, __HIP_MEMORY_SCOPE_AGENT); }
__device__ __forceinline__ unsigned xb_xcc_id() { return (unsigned)__builtin_amdgcn_s_getreg((3 << 11) | 20) & 0xFu; }
#define XB_SPIN(cond, bar) do { unsigned _sp = 0; while (cond) { __builtin_amdgcn_s_sleep(1); \
    if ((++_sp & 255u) == 0u) { if (xb_ld(&(bar)[XB_TMO])) break; if (_sp > XB_SPIN_CAP) { atomicAdd(&(bar)[XB_TMO], 1u); break; } } } } while (0)

struct XcdBarrier {
    unsigned* bar; unsigned x;
    volatile LAS unsigned* st;
};

__device__ __forceinline__ XcdBarrier xcd_barrier_post(unsigned* bar, volatile LAS unsigned* st) {
    XcdBarrier b; b.bar = bar; b.x = xb_xcc_id(); b.st = st;
    if (threadIdx.x == 0) (void)xb_add(&bar[XB_XCNT(b.x)], 1u);
    return b;
}
__device__ __forceinline__ void xcd_barrier_complete(unsigned* bar, unsigned x, unsigned& nloc, unsigned& nx) {
    const unsigned G = gridDim.x * gridDim.y * gridDim.z;
    unsigned sum, cnt, mine, sp = 0u;
    for (;;) {
        sum = 0u; cnt = 0u; mine = 0u;
#pragma unroll
        for (unsigned j = 0; j < 16; ++j) { const unsigned c = xb_ld(&bar[XB_XCNT(j)]); sum += c; cnt += (c > 0u) ? 1u : 0u; mine = (j == x) ? c : mine; }
        if (sum == G) break;
        __builtin_amdgcn_s_sleep(1);
        if ((++sp & 255u) == 0u) { if (xb_ld(&bar[XB_TMO])) break; if (sp > XB_SPIN_CAP) { atomicAdd(&bar[XB_TMO], 1u); break; } }
    }
    nloc = mine > 0u ? mine : 1u; nx = cnt > 0u ? cnt : 1u;
}

__device__ __forceinline__ void xcd_barrier(const XcdBarrier& b) {
    asm volatile("s_waitcnt vmcnt(0)" ::: "memory");
    __syncthreads();
    if (threadIdx.x == 0) {
        unsigned* bar = b.bar;
        __builtin_amdgcn_s_waitcnt(0);
        unsigned nloc = b.st[0], nx = b.st[1];
        if (nloc == 0u) { xcd_barrier_complete(bar, b.x, nloc, nx); b.st[0] = nloc; b.st[1] = nx; }
        const unsigned old = xb_add(&bar[XB_XSUB(b.x)], 1u);
        const unsigned gen = old / nloc;
        if (old + 1u == (gen + 1u) * nloc) {
            __builtin_amdgcn_fence(__ATOMIC_RELEASE, "agent");
            asm volatile("s_waitcnt vmcnt(0)" ::: "memory");
            const unsigned og = xb_add(&bar[XB_TOP], 1u);
            const unsigned tg = og / nx;
            if (og + 1u == (tg + 1u) * nx) xb_add(&bar[XB_TOPGEN], 1u);
            else XB_SPIN(xb_ld(&bar[XB_TOPGEN]) == tg, bar);
            __builtin_amdgcn_fence(__ATOMIC_ACQUIRE, "agent");
            xb_add(&bar[XB_XGEN(b.x)], 1u);
            asm volatile("s_waitcnt vmcnt(0)" ::: "memory");
        } else {
            XB_SPIN(xb_ld(&bar[XB_XGEN(b.x)]) == gen, bar);
            __builtin_amdgcn_fence(__ATOMIC_ACQUIRE, "agent");
            asm volatile("s_waitcnt vmcnt(0)" ::: "memory");
        }
    }
    __syncthreads();
}

constexpr int NWAVES = 8;
constexpr int M = 16384, D = 1024, FF = 4096, NIN = 2576, NP = 2816;
constexpr int C_Q = 0, C_K = 256, C_V = 512, C_G = 1024, C_CI = 1536, C_CG = 2048, C_Z = 2560;
constexpr int NCHUNK = M / 64;
constexpr float EPS = 1e-6f;

constexpr size_t MiB = 1u << 20;
constexpr size_t WS_CTL = 0, CTL_ZERO_BYTES = 1 * MiB;
constexpr size_t WS_WIN = 2 * MiB, WS_WO = 8 * MiB, WS_W1 = 10 * MiB, WS_W2 = 18 * MiB;
constexpr size_t WS_SSQ2 = 26 * MiB, WS_SSQ3 = 27 * MiB, WS_DEC = 28 * MiB;
constexpr size_t WS_XN = 32 * MiB;
constexpr size_t WS_PROJ = 64 * MiB;
constexpr size_t WS_MIX = 152 * MiB;
constexpr size_t WS_KV = 184 * MiB;
constexpr size_t WS_ST = 216 * MiB;
constexpr size_t WS_FF = 64 * MiB;
constexpr size_t WS_END = 256 * MiB;
constexpr int CW_BAR = 4096;

constexpr int RING_OFF = 0, RING_BYTES = 131072;
constexpr int LDSCTL_OFF = RING_BYTES, MISC_OFF = LDSCTL_OFF + 320;
constexpr int LDS_BYTES = 147456;

__device__ __forceinline__ float bf2f(unsigned short b) { return __builtin_bit_cast(float, (unsigned)b << 16); }
__device__ __forceinline__ unsigned short f2bf_s(float f) { return (unsigned short)f2bf(f); }
__device__ __forceinline__ float wave_sum(float v) {
#pragma unroll
    for (int o = 1; o < 64; o <<= 1) v += __shfl_xor(v, o);
    return v;
}
__device__ __forceinline__ float sigmoidf_(float x) { return 1.0f / (1.0f + __expf(-x)); }
__device__ __forceinline__ float logsigmoidf_(float a) { return fminf(a, 0.f) - __logf(1.0f + __expf(-fabsf(a))); }

struct Frame {
    unsigned char* lds;
    volatile LAS unsigned* MISC;
    gu32* ctl;
    int tid, lane, wave, vcu, G;
    const float *x, *norm1_g, *w_in, *w_gate_up, *b_gate, *gla_norm_g, *conv_w, *conv_b, *conv_norm_g, *conv_norm_b, *w_out, *norm2_g, *w_mlp_in, *w_mlp_out, *final_norm_g;
    float* out;
    bf16 *Win_t, *Wo_t, *W1_t, *W2_t, *XN, *PROJ, *MIX, *ST, *FFB;
    float *SSQ2, *SSQ3, *DEC, *KV;
};

template <bool WIN>
__device__ __forceinline__ void p0_transpose_item(const float* W, int K, int N, int Nout, const float* gain, bf16* WT, float* scr, int item, int lane) {
    const int nblk = Nout / 32, kb = item / nblk, nb = item % nblk, k0 = 64 * kb, n0 = 32 * nb;
    const int n = n0 + (lane & 31);
    int src = n; float cs = 1.f;
    if (WIN) { if (n < 1536) src = n; else if (n < 2560) src = n + 16; else if (n < 2576) src = n - 1024; else src = -1; if (n < 256) cs = 0.125f; }
#pragma unroll 8
    for (int i = 0; i < 32; ++i) { const int kk = 2 * i + (lane >> 5); float v = 0.f; if (src >= 0) v = W[(size_t)(k0 + kk) * N + src] * cs; if (gain) v *= gain[k0 + kk]; scr[kk * 33 + (lane & 31)] = v; }
    LDS_WAIT(); asm volatile("" ::: "memory");
    const int c = lane & 7;
#pragma unroll
    for (int j = 0; j < 4; ++j) { const int nn = (lane >> 3) + 8 * j; const float* s = scr + (8 * c) * 33 + nn;
        v4u o; o.x = pk2(s[0 * 33], s[1 * 33]); o.y = pk2(s[2 * 33], s[3 * 33]); o.z = pk2(s[4 * 33], s[5 * 33]); o.w = pk2(s[6 * 33], s[7 * 33]);
        *(v4u*)(WT + (size_t)(n0 + nn) * K + k0 + 8 * c) = o; }
    LDS_WAIT(); asm volatile("" ::: "memory");
}
__device__ __forceinline__ void p0_prologue(Frame& F) {
    float* scr = (float*)(F.lds + RING_OFF + F.wave * 16384);
    const int gw = F.vcu * NWAVES + F.wave, NGW = F.G * NWAVES;
    constexpr int I_IN = (D / 64) * (NP / 32), I_O = (D / 64) * (D / 32), I_1 = (D / 64) * (FF / 32), I_2 = (FF / 64) * (D / 32);
    constexpr int NITEMS = I_IN + I_O + I_1 + I_2;
    for (int it = gw; it < NITEMS; it += NGW) {
        int r = it;
        if (r < I_IN) { p0_transpose_item<true>(F.w_in, D, NIN, NP, nullptr, F.Win_t, scr, r, F.lane); continue; } r -= I_IN;
        if (r < I_O) { p0_transpose_item<false>(F.w_out, D, D, D, nullptr, F.Wo_t, scr, r, F.lane); continue; } r -= I_O;
        if (r < I_1) { p0_transpose_item<false>(F.w_mlp_in, D, FF, FF, F.norm2_g, F.W1_t, scr, r, F.lane); continue; } r -= I_1;
        p0_transpose_item<false>(F.w_mlp_out, FF, D, D, nullptr, F.W2_t, scr, r, F.lane);
    }
    for (int m = gw; m < M; m += NGW) {
        const f32x4* xr = (const f32x4*)(F.x + (size_t)m * D) + F.lane; const f32x4* gr = (const f32x4*)F.norm1_g + F.lane;
        f32x4 v[4]; float s = 0.f;
#pragma unroll
        for (int j = 0; j < 4; ++j) { v[j] = xr[64 * j]; s += (v[j].x * v[j].x + v[j].y * v[j].y) + (v[j].z * v[j].z + v[j].w * v[j].w); }
        const float rstd = 1.0f / sqrtf(wave_sum(s) * (1.f / D) + EPS);
        unsigned long long* o8 = (unsigned long long*)(F.XN + (size_t)m * D) + F.lane;
#pragma unroll
        for (int j = 0; j < 4; ++j) { const f32x4 g = gr[64 * j]; o8[64 * j] = (unsigned long long)pk2(v[j].x * rstd * g.x, v[j].y * rstd * g.y) | ((unsigned long long)pk2(v[j].z * rstd * g.z, v[j].w * rstd * g.w) << 32); }
    }
}

constexpr int GP = 72;
constexpr int L_VT = 0;
constexpr int L_XA = L_VT + 2 * 128 * GP * 2;
constexpr int L_XB = L_XA + 2 * 64 * GP * 2;
constexpr int L_PS = L_XB + 2 * 64 * GP * 2;
constexpr int L_ZS = L_PS + 2 * 64 * GP * 2;
constexpr int L_TS = L_ZS + 64 * 16 * 4;
static_assert(L_TS + 2 * 4 * 64 * 4 <= RING_BYTES, "GLA LDS map");

__device__ __forceinline__ void gla_setup(Frame& F, int c, int hp, float (&bl)[16], float& b_last) {
    unsigned char* L = F.lds + RING_OFF;
    const int tid = F.tid, lane = F.lane, hl = F.wave >> 2, sg = F.wave & 3, h = 2 * hp + hl, t0 = 64 * c;
    float* ZS = (float*)(L + L_ZS); float* TS = (float*)(L + L_TS); bf16* VT = (bf16*)(L + L_VT);
#pragma unroll
    for (int i = 0; i < 2; ++i) { const int idx = tid + 512 * i, t = idx >> 4, r = idx & 15; ZS[t * 16 + r] = bf2f(F.PROJ[(size_t)(t0 + t) * NP + C_Z + r]); }
#pragma unroll
    for (int i = 0; i < 4; ++i) { const int idx = tid + 512 * i, t = idx & 63, cv = idx >> 6;
        const v4u w = *(const v4u*)(F.PROJ + (size_t)(t0 + t) * NP + C_V + hp * 256 + cv * 8);
        bf16* dst = VT + (size_t)(cv * 8) * GP + t;
        dst[0 * GP] = (bf16)(w.x & 0xffffu); dst[1 * GP] = (bf16)(w.x >> 16); dst[2 * GP] = (bf16)(w.y & 0xffffu); dst[3 * GP] = (bf16)(w.y >> 16);
        dst[4 * GP] = (bf16)(w.z & 0xffffu); dst[5 * GP] = (bf16)(w.z >> 16); dst[6 * GP] = (bf16)(w.w & 0xffffu); dst[7 * GP] = (bf16)(w.w >> 16); }
    float wg[16];
#pragma unroll
    for (int r = 0; r < 16; ++r) wg[r] = F.w_gate_up[r * 256 + h * 64 + lane];
    const float bgv = F.b_gate[h * 64 + lane];
    __syncthreads();
    float run = 0.f;
#pragma unroll
    for (int i = 0; i < 16; ++i) { const f32x4* zr = (const f32x4*)(ZS + (16 * sg + i) * 16); float a = bgv;
#pragma unroll
        for (int q = 0; q < 4; ++q) { const f32x4 z = zr[q]; a += z.x * wg[4 * q] + z.y * wg[4 * q + 1] + z.z * wg[4 * q + 2] + z.w * wg[4 * q + 3]; }
        run += logsigmoidf_(a) * (1.0f / 16.0f); bl[i] = run; }
    TS[(hl * 4 + sg) * 64 + lane] = run;
    __syncthreads();
    float off = 0.f, tot = 0.f;
#pragma unroll
    for (int s = 0; s < 4; ++s) { const float v = TS[(hl * 4 + s) * 64 + lane]; if (s < sg) off += v; tot += v; }
#pragma unroll
    for (int i = 0; i < 16; ++i) bl[i] += off;
    b_last = tot;
}

__device__ __forceinline__ void gla1_item(Frame& F, int c, int hp) {
    unsigned char* L = F.lds + RING_OFF;
    const int lane = F.lane, hl = F.wave >> 2, sg = F.wave & 3, h = 2 * hp + hl, t0 = 64 * c, fr = lane & 15, fq = lane >> 4;
    float bl[16], b_last;
    gla_setup(F, c, hp, bl, b_last);
    bf16* VT = (bf16*)(L + L_VT); bf16* KDT = (bf16*)(L + L_XA);
    {
        unsigned pk[8];
#pragma unroll
        for (int i = 0; i < 16; i += 2) {
            const float k0 = bf2f(F.PROJ[(size_t)(t0 + 16 * sg + i) * NP + C_K + h * 64 + lane]), k1 = bf2f(F.PROJ[(size_t)(t0 + 16 * sg + i + 1) * NP + C_K + h * 64 + lane]);
            pk[i >> 1] = pg8::cvt_pk_bf16(k0 * __expf(b_last - bl[i]), k1 * __expf(b_last - bl[i + 1]));
        }
        v4u* dst = (v4u*)(KDT + (size_t)(hl * 64 + lane) * GP + 16 * sg);
        dst[0] = (v4u){pk[0], pk[1], pk[2], pk[3]}; dst[1] = (v4u){pk[4], pk[5], pk[6], pk[7]};
        if (sg == 0) F.DEC[(c * 4 + h) * 64 + lane] = __expf(b_last);
    }
    __syncthreads();
    f32x4 acc[2][4];
#pragma unroll
    for (int et = 0; et < 2; ++et)
#pragma unroll
        for (int dt = 0; dt < 4; ++dt) acc[et][dt] = (f32x4){0.f, 0.f, 0.f, 0.f};
#pragma unroll
    for (int kk = 0; kk < 2; ++kk) {
        bf16x8 a[2], b[4];
#pragma unroll
        for (int et = 0; et < 2; ++et) a[et] = *(const bf16x8*)(VT + (size_t)(hl * 128 + 32 * sg + 16 * et + fr) * GP + kk * 32 + fq * 8);
#pragma unroll
        for (int dt = 0; dt < 4; ++dt) b[dt] = *(const bf16x8*)(KDT + (size_t)(hl * 64 + 16 * dt + fr) * GP + kk * 32 + fq * 8);
#pragma unroll
        for (int et = 0; et < 2; ++et)
#pragma unroll
            for (int dt = 0; dt < 4; ++dt) acc[et][dt] = __builtin_amdgcn_mfma_f32_16x16x32_bf16(a[et], b[dt], acc[et][dt], 0, 0, 0);
    }
    float* kv = F.KV + (size_t)(c * 4 + h) * 128 * 64;
#pragma unroll
    for (int et = 0; et < 2; ++et)
#pragma unroll
        for (int dt = 0; dt < 4; ++dt)
#pragma unroll
            for (int jj = 0; jj < 4; ++jj) kv[(size_t)(32 * sg + 16 * et + 4 * fq + jj) * 64 + 16 * dt + fr] = acc[et][dt][jj];
    __syncthreads();
}

__device__ __forceinline__ void scan_item(Frame& F, int item) {
    float* AG = (float*)(F.lds + RING_OFF);
    const int lane = F.lane, w = F.wave;
    const int el = item * 64 + lane, h = el >> 13, ed = el & 8191;
    float kv[32], dc[32];
#pragma unroll
    for (int i = 0; i < 32; ++i) { const int c = 32 * w + i; kv[i] = F.KV[(size_t)(c * 4 + h) * 8192 + ed]; dc[i] = F.DEC[(c * 4 + h) * 64 + lane]; }
    float s = 0.f, p = 1.f;
#pragma unroll
    for (int i = 0; i < 32; ++i) { const float k = kv[i], d = dc[i]; kv[i] = s; dc[i] = p; s = d * s + k; p = p * d; }
    AG[(w * 64 + lane) * 2] = p; AG[(w * 64 + lane) * 2 + 1] = s;
    __syncthreads();
    float S = 0.f;
    for (int ww = 0; ww < w; ++ww) S = AG[(ww * 64 + lane) * 2] * S + AG[(ww * 64 + lane) * 2 + 1];
#pragma unroll
    for (int i = 0; i < 32; ++i) { const int c = 32 * w + i; F.ST[(size_t)(c * 4 + h) * 8192 + ed] = f2bf_s(kv[i] + dc[i] * S); }
    __syncthreads();
}

__device__ __forceinline__ void gla3_item(Frame& F, int c, int hp) {
    unsigned char* L = F.lds + RING_OFF;
    const int lane = F.lane, hl = F.wave >> 2, sg = F.wave & 3, h = 2 * hp + hl, t0 = 64 * c, fr = lane & 15, fq = lane >> 4;
    float bl[16], b_last;
    gla_setup(F, c, hp, bl, b_last);
    bf16* VT = (bf16*)(L + L_VT); bf16* QB = (bf16*)(L + L_XA); bf16* KB = (bf16*)(L + L_XB); bf16* PS = (bf16*)(L + L_PS);
#pragma unroll
    for (int i = 0; i < 16; ++i) { const size_t ro = (size_t)(t0 + 16 * sg + i) * NP + h * 64 + lane;
        const float qv = bf2f(F.PROJ[ro + C_Q]), kv = bf2f(F.PROJ[ro + C_K]);
        QB[(size_t)(hl * 64 + 16 * sg + i) * GP + lane] = f2bf_s(qv * __expf(bl[i]));
        KB[(size_t)(hl * 64 + 16 * sg + i) * GP + lane] = f2bf_s(kv * __expf(-bl[i])); }
    __syncthreads();
    bf16x8 aq[2];
#pragma unroll
    for (int kk = 0; kk < 2; ++kk) aq[kk] = *(const bf16x8*)(QB + (size_t)(hl * 64 + 16 * sg + fr) * GP + kk * 32 + fq * 8);
#pragma unroll
    for (int jt = 0; jt < 4; ++jt) {
        f32x4 s = (f32x4){0.f, 0.f, 0.f, 0.f};
#pragma unroll
        for (int kk = 0; kk < 2; ++kk) { const bf16x8 b = *(const bf16x8*)(KB + (size_t)(hl * 64 + 16 * jt + fr) * GP + kk * 32 + fq * 8); s = __builtin_amdgcn_mfma_f32_16x16x32_bf16(aq[kk], b, s, 0, 0, 0); }
#pragma unroll
        for (int jj = 0; jj < 4; ++jj) { const int i = 16 * sg + 4 * fq + jj, j = 16 * jt + fr; PS[(size_t)(hl * 64 + i) * GP + j] = f2bf_s(j <= i ? s[jj] : 0.f); }
    }
    __syncthreads();
    f32x4 acc[8];
#pragma unroll
    for (int et = 0; et < 8; ++et) acc[et] = (f32x4){0.f, 0.f, 0.f, 0.f};
    const bf16* st = F.ST + (size_t)(c * 4 + h) * 8192;
#pragma unroll
    for (int kk = 0; kk < 2; ++kk) {
        const bf16x8 ap = *(const bf16x8*)(PS + (size_t)(hl * 64 + 16 * sg + fr) * GP + kk * 32 + fq * 8);
#pragma unroll
        for (int et = 0; et < 8; ++et) { const bf16x8 b = *(const bf16x8*)(VT + (size_t)(hl * 128 + 16 * et + fr) * GP + kk * 32 + fq * 8); acc[et] = __builtin_amdgcn_mfma_f32_16x16x32_bf16(ap, b, acc[et], 0, 0, 0); }
#pragma unroll
        for (int et = 0; et < 8; ++et) { const bf16x8 b = *(const bf16x8*)(st + (size_t)(16 * et + fr) * 64 + kk * 32 + fq * 8); acc[et] = __builtin_amdgcn_mfma_f32_16x16x32_bf16(aq[kk], b, acc[et], 0, 0, 0); }
    }
    float rs[4];
#pragma unroll
    for (int jj = 0; jj < 4; ++jj) { float ss = 0.f;
#pragma unroll
        for (int et = 0; et < 8; ++et) ss += acc[et][jj] * acc[et][jj];
        ss += __shfl_xor(ss, 1); ss += __shfl_xor(ss, 2); ss += __shfl_xor(ss, 4); ss += __shfl_xor(ss, 8);
        rs[jj] = 1.0f / sqrtf(ss * (1.0f / 128.0f) + EPS); }
#pragma unroll
    for (int et = 0; et < 8; ++et) { const float gn = F.gla_norm_g[16 * et + fr];
#pragma unroll
        for (int jj = 0; jj < 4; ++jj) { const int t = t0 + 16 * sg + 4 * fq + jj, col = h * 128 + 16 * et + fr;
            const float g = bf2f(F.PROJ[(size_t)t * NP + C_G + col]);
            F.MIX[(size_t)t * D + col] = f2bf_s(acc[et][jj] * rs[jj] * gn * g * sigmoidf_(g)); } }
    __syncthreads();
}

__device__ __forceinline__ void conv_item(Frame& F, int T) {
    const int ch = F.tid, t0 = 64 * T;
    float w[31];
#pragma unroll
    for (int j = 0; j < 31; ++j) w[j] = F.conv_w[j * 512 + ch];
    const float cb = F.conv_b[ch], gg = F.conv_norm_g[ch], gb = F.conv_norm_b[ch];
    float win[38];
#pragma unroll
    for (int i = 0; i < 30; ++i) { const int t = t0 - 30 + i; float u = 0.f;
        if (t >= 0) { const float ci = bf2f(F.PROJ[(size_t)t * NP + C_CI + ch]), cg = bf2f(F.PROJ[(size_t)t * NP + C_CG + ch]); u = ci * sigmoidf_(cg); }
        win[i] = u; }
#pragma unroll 1
    for (int blk = 0; blk < 8; ++blk) {
#pragma unroll
        for (int i = 0; i < 8; ++i) { const int t = t0 + 8 * blk + i; const float ci = bf2f(F.PROJ[(size_t)t * NP + C_CI + ch]), cg = bf2f(F.PROJ[(size_t)t * NP + C_CG + ch]); win[30 + i] = ci * sigmoidf_(cg); }
#pragma unroll
        for (int o = 0; o < 8; ++o) { float y = cb;
#pragma unroll
            for (int j = 0; j < 31; ++j) y += win[o + j] * w[j];
            const float mean = wave_sum(y) * (1.0f / 64.0f), dl = y - mean, var = wave_sum(dl * dl) * (1.0f / 64.0f);
            const float yn = dl * (1.0f / sqrtf(var + EPS)) * gg + gb;
            F.MIX[(size_t)(t0 + 8 * blk + o) * D + 512 + ch] = f2bf_s(yn * sigmoidf_(yn)); }
#pragma unroll
        for (int i = 0; i < 30; ++i) win[i] = win[i + 8];
    }
}

__device__ __forceinline__ void final_norm(Frame& F) {
    const int gw = F.vcu * NWAVES + F.wave, NGW = F.G * NWAVES;
    for (int m = gw; m < M; m += NGW) {
        const f32x4* sp = (const f32x4*)(F.SSQ3 + (size_t)m * 16); const f32x4 a = sp[0], b = sp[1], c = sp[2], d = sp[3];
        const float t = ((a[0] + a[1]) + (a[2] + a[3])) + ((b[0] + b[1]) + (b[2] + b[3])) + ((c[0] + c[1]) + (c[2] + c[3])) + ((d[0] + d[1]) + (d[2] + d[3]));
        const float rstd = 1.0f / sqrtf(t * (1.0f / D) + EPS);
        f32x4* xr = (f32x4*)(F.out + (size_t)m * D) + F.lane; const f32x4* gr = (const f32x4*)F.final_norm_g + F.lane;
#pragma unroll
        for (int j = 0; j < 4; ++j) { const f32x4 v = xr[64 * j], g = gr[64 * j]; xr[64 * j] = v * rstd * g; }
    }
}

struct Args { const float* in[15]; float* out; unsigned char* ws; };
__global__ void __launch_bounds__(NWAVES * 64, 2) fwd_megakernel(Args args) {
    extern __shared__ __attribute__((aligned(16))) unsigned char lds[];
    Frame F;
    F.lds = lds;
    F.MISC = (volatile LAS unsigned*)((LAS unsigned char*)lds + MISC_OFF);
    F.tid = threadIdx.x; F.lane = F.tid & 63; F.wave = __builtin_amdgcn_readfirstlane(F.tid >> 6);
    F.G = gridDim.x; { const int bx = blockIdx.x; F.vcu = (F.G % 8 == 0) ? (bx % 8) * (F.G / 8) + bx / 8 : bx; }
    unsigned char* ws = args.ws;
    F.ctl = (gu32*)(ws + WS_CTL);
    F.x = args.in[0]; F.norm1_g = args.in[1]; F.w_in = args.in[2]; F.w_gate_up = args.in[3]; F.b_gate = args.in[4]; F.gla_norm_g = args.in[5]; F.conv_w = args.in[6]; F.conv_b = args.in[7];
    F.conv_norm_g = args.in[8]; F.conv_norm_b = args.in[9]; F.w_out = args.in[10]; F.norm2_g = args.in[11]; F.w_mlp_in = args.in[12]; F.w_mlp_out = args.in[13]; F.final_norm_g = args.in[14];
    F.out = args.out;
    F.Win_t = (bf16*)(ws + WS_WIN); F.Wo_t = (bf16*)(ws + WS_WO); F.W1_t = (bf16*)(ws + WS_W1); F.W2_t = (bf16*)(ws + WS_W2);
    F.XN = (bf16*)(ws + WS_XN); F.PROJ = (bf16*)(ws + WS_PROJ); F.MIX = (bf16*)(ws + WS_MIX); F.ST = (bf16*)(ws + WS_ST); F.FFB = (bf16*)(ws + WS_FF);
    F.SSQ2 = (float*)(ws + WS_SSQ2); F.SSQ3 = (float*)(ws + WS_SSQ3); F.DEC = (float*)(ws + WS_DEC); F.KV = (float*)(ws + WS_KV);
    for (int u = F.tid; u < (LDS_BYTES - LDSCTL_OFF) / 4; u += NWAVES * 64) ((LAS unsigned*)((LAS unsigned char*)lds + LDSCTL_OFF))[u] = 0u;
    __syncthreads();
    XcdBarrier bar = xcd_barrier_post((unsigned*)(F.ctl + CW_BAR), F.MISC + 8);
    LAS unsigned char* ring = (LAS unsigned char*)lds + RING_OFF;

    p0_prologue(F);
    xcd_barrier(bar);
    {
        pg8::Gemm g{F.XN, F.Win_t, M, NP, D}; pg8::StaticOrder S; S.init(M, NP, F.G, (int)blockIdx.x);
        pg8::EpiBf16<0> E{F.PROJ, NP, nullptr, 0, 0, 1.f};
        pg8::gemm_phase<pg8::EpiBf16<0>, pg8::StaticOrder, PG8_ALIGN, PG8_SP2>(ring, g, S, E);
    }
    xcd_barrier(bar);
    for (int it = F.vcu; it < NCHUNK * 2; it += F.G) gla1_item(F, it >> 1, it & 1);
    for (int T = F.vcu; T < NCHUNK; T += F.G) conv_item(F, T);
    xcd_barrier(bar);
    for (int it = F.vcu; it < 512; it += F.G) scan_item(F, it);
    xcd_barrier(bar);
    for (int it = F.vcu; it < NCHUNK * 2; it += F.G) gla3_item(F, it >> 1, it & 1);
    xcd_barrier(bar);
    {
        pg8::Gemm g{F.MIX, F.Wo_t, M, D, D}; pg8::StaticOrder S; S.init(M, D, F.G, (int)blockIdx.x);
        pg8::EpiResid E{F.x, F.out, F.XN, F.SSQ2, D};
        pg8::gemm_phase<pg8::EpiResid, pg8::StaticOrder, PG8_ALIGN, PG8_SP2>(ring, g, S, E);
    }
    xcd_barrier(bar);
    {
        pg8::Gemm g{F.XN, F.W1_t, M, FF, D}; pg8::StaticOrder S; S.init(M, FF, F.G, (int)blockIdx.x);
        pg8::EpiRelu2 E{F.FFB, FF, F.SSQ2, 1.0f / D, EPS};
        pg8::gemm_phase<pg8::EpiRelu2, pg8::StaticOrder, PG8_ALIGN, PG8_SP2>(ring, g, S, E);
    }
    xcd_barrier(bar);
    {
        pg8::Gemm g{F.FFB, F.W2_t, M, D, FF}; pg8::StaticOrder S; S.init(M, D, F.G, (int)blockIdx.x);
        pg8::EpiResid E{F.out, F.out, nullptr, F.SSQ3, D};
        pg8::gemm_phase<pg8::EpiResid, pg8::StaticOrder, PG8_ALIGN, PG8_SP2>(ring, g, S, E);
    }
    xcd_barrier(bar);
    final_norm(F);
}

extern "C" void kernel_launch(void* const* d_in, const int* in_sizes, int n_in, void* d_out, int out_size, void* d_ws, size_t ws_size, hipStream_t stream) {
    static int grid = 0;
    if (grid == 0) {
        if (n_in != 15 || in_sizes[0] != M * D || out_size != M * D || ws_size < WS_END) { fprintf(stderr, "kernel_launch: unexpected shapes (n_in %d, in0 %d, out %d, ws %zu)\n", n_in, n_in > 0 ? in_sizes[0] : -1, out_size, ws_size); grid = -1; return; }
        int dev = 0, cus = 0, per_cu = 0;
        if (hipGetDevice(&dev) != hipSuccess || hipDeviceGetAttribute(&cus, hipDeviceAttributeMultiprocessorCount, dev) != hipSuccess) { grid = -1; return; }
        if (hipFuncSetAttribute((const void*)fwd_megakernel, hipFuncAttributeMaxDynamicSharedMemorySize, LDS_BYTES) != hipSuccess) { fprintf(stderr, "kernel_launch: hipFuncSetAttribute failed\n"); grid = -1; return; }
        if (hipOccupancyMaxActiveBlocksPerMultiprocessor(&per_cu, (const void*)fwd_megakernel, NWAVES * 64, LDS_BYTES) != hipSuccess || per_cu < 1) { fprintf(stderr, "kernel_launch: occupancy query reports %d blocks per CU\n", per_cu); }
        (void)hipGetLastError();
        grid = cus;
    }
    if (grid < 0) return;
    if (hipMemsetAsync((char*)d_ws + WS_CTL, 0, CTL_ZERO_BYTES, stream) != hipSuccess) { fprintf(stderr, "kernel_launch: hipMemsetAsync failed\n"); return; }
    Args a{};
    for (int i = 0; i < 15; ++i) a.in[i] = (const float*)d_in[i];
    a.out = (float*)d_out; a.ws = (unsigned char*)d_ws;
    hipLaunchKernelGGL(fwd_megakernel, dim3(grid), dim3(NWAVES * 64), LDS_BYTES, stream, a);
    const hipError_t le = hipPeekAtLastError();
    if (le != hipSuccess) fprintf(stderr, "kernel_launch: launch failed: %s\n", hipGetErrorName(le));
}
```
